# Optimizing an MI355X kernel written in HIP

```python
import jax, jax.numpy as jnp
from jax import lax
import numpy as np

D_MODEL = 1024
BATCH = 4
SEQ = 4096
DEPTH = 1
DEC_BATCH = 128
DEC_SEQ = 8
PAST_LEN = 16384
PAGE_SIZE = 128

HEAD_DIM = 64
ATT_HEADS = 8
KV_HEADS = 2
Q_PER_KV = ATT_HEADS // KV_HEADS
ATT_WIDTH = ATT_HEADS * HEAD_DIM
KV_WIDTH = KV_HEADS * HEAD_DIM
GM_HEADS = 8
GM_WIDTH = GM_HEADS * HEAD_DIM
MIX_WIDTH = ATT_WIDTH + GM_WIDTH
IN_WIDTH = ATT_WIDTH + 2 * KV_WIDTH + 2 * GM_WIDTH
WINDOW = 128
CHUNK = 128
ROPE_THETA = 500000.0
ROT_DIM = HEAD_DIM // 4
D_FF = ((8 * D_MODEL + 3 * 256 - 1) // (3 * 256)) * 256
ALPHA = (2 * DEPTH) ** 0.25
BETA = (8 * DEPTH) ** -0.25
LN_EPS = 1e-5
ATT_SCALE = HEAD_DIM ** -0.5

kernel_name = "hymba_sgu_swa_sink_deepnorm_adaln_step"


def _layer_norm(x, gain=None, bias=None):
    xf = x.astype(jnp.float32)
    mu = jnp.mean(xf, axis=-1, keepdims=True)
    var = jnp.mean(jnp.square(xf - mu), axis=-1, keepdims=True)
    y = (xf - mu) * lax.rsqrt(var + LN_EPS)
    if gain is not None:
        y = y * gain.astype(jnp.float32) + bias.astype(jnp.float32)
    return y.astype(x.dtype)


def _adaln(c, w_ada, b_ada):
    mod = jax.nn.silu(c) @ w_ada + b_ada
    return jnp.split(mod[:, None, :], 6, axis=-1)


def _modulate(x, shift, scale):
    return _layer_norm(x) * (1 + scale) + shift


def _rotary(x, pos):
    half = ROT_DIM // 2
    inv_freq = jnp.power(jnp.float32(ROPE_THETA), -jnp.arange(half, dtype=jnp.float32) * 2.0 / ROT_DIM)
    ang = pos.astype(jnp.float32)[:, None] * inv_freq[None, :]
    cos = jnp.cos(ang)[:, None, :]
    sin = jnp.sin(ang)[:, None, :]
    xf = x.astype(jnp.float32)
    x1 = xf[..., :half]
    x2 = xf[..., half:ROT_DIM]
    out = jnp.concatenate([x1 * cos - x2 * sin, x2 * cos + x1 * sin, xf[..., ROT_DIM:]], axis=-1)
    return out.astype(x.dtype)


def _project(h, w_in, pos, sgu_g, sgu_b):
    n, s, _ = h.shape
    z = h @ w_in
    q, k, v, zu, zv = jnp.split(z, [ATT_WIDTH, ATT_WIDTH + KV_WIDTH, ATT_WIDTH + 2 * KV_WIDTH,
                                    ATT_WIDTH + 2 * KV_WIDTH + GM_WIDTH], axis=-1)
    q = _rotary(q.reshape(n, s, ATT_HEADS, HEAD_DIM), pos)
    k = _rotary(k.reshape(n, s, KV_HEADS, HEAD_DIM), pos)
    v = v.reshape(n, s, KV_HEADS, HEAD_DIM)
    u = jax.nn.gelu(zu)
    gv = _layer_norm(jax.nn.gelu(zv), sgu_g, sgu_b)
    return q, k, v, u, gv


def _sink_weights(scores, mask, sinks):
    scores = jnp.where(mask, scores, -jnp.inf)
    sink = jnp.broadcast_to(sinks.astype(jnp.float32).reshape(KV_HEADS, Q_PER_KV, 1, 1),
                            scores.shape[:-1] + (1,))
    p = jax.nn.softmax(jnp.concatenate([scores, sink], axis=-1), axis=-1)
    return p[..., :-1]


def _attn_prompt(q, k, v, sinks):
    n, s = q.shape[0], q.shape[1]
    nb = s // WINDOW
    qb = q.reshape(n, nb, WINDOW, KV_HEADS, Q_PER_KV, HEAD_DIM)
    kb = k.reshape(n, nb, WINDOW, KV_HEADS, HEAD_DIM)
    vb = v.reshape(n, nb, WINDOW, KV_HEADS, HEAD_DIM)
    pad = ((0, 0), (1, 0), (0, 0), (0, 0), (0, 0))
    kk = jnp.concatenate([jnp.pad(kb, pad)[:, :-1], kb], axis=2)
    vv = jnp.concatenate([jnp.pad(vb, pad)[:, :-1], vb], axis=2)
    scores = jnp.einsum('bnqkgd,bnskd->bnkgqs', qb, kk, preferred_element_type=jnp.float32) * ATT_SCALE
    qi = jnp.arange(WINDOW)[:, None]
    sj = jnp.arange(2 * WINDOW)[None, :]
    rel = qi + WINDOW - sj
    band = (rel >= 0) & (rel < WINDOW)
    valid = (jnp.arange(nb)[:, None, None] > 0) | (sj[None] >= WINDOW)
    mask = (band[None] & valid)[None, :, None, None]
    p = _sink_weights(scores, mask, sinks)
    o = jnp.einsum('bnkgqs,bnskd->bnqkgd', p.astype(vv.dtype), vv)
    return o.reshape(n, s, ATT_WIDTH)


def _attn_sample(q, k, v, k_buf, v_buf, sinks):
    n, t = q.shape[0], q.shape[1]
    wb = k_buf.shape[1]
    kk = jnp.concatenate([k_buf, k], axis=1)
    vv = jnp.concatenate([v_buf, v], axis=1)
    qg = q.reshape(n, t, KV_HEADS, Q_PER_KV, HEAD_DIM)
    scores = jnp.einsum('bqkgd,bskd->bkgqs', qg, kk, preferred_element_type=jnp.float32) * ATT_SCALE
    q_pos = PAST_LEN + jnp.arange(t)
    k_pos = PAST_LEN - wb + jnp.arange(wb + t)
    rel = q_pos[:, None] - k_pos[None, :]
    mask = (rel >= 0) & (rel < WINDOW)
    p = _sink_weights(scores, mask, sinks)
    o = jnp.einsum('bkgqs,bskd->bqkgd', p.astype(vv.dtype), vv)
    return o.reshape(n, t, ATT_WIDTH), kk[:, -wb:], vv[:, -wb:]


def _sgu_prompt(u, gv, w_s, b_s):
    n, s, _ = u.shape
    nc = s // CHUNK
    vc = gv.reshape(n, nc, CHUNK, GM_HEADS, HEAD_DIM)
    sv = jnp.einsum('hts,bnshd->bnthd', jnp.tril(w_s), vc) + b_s.T[:, :, None]
    return u * sv.reshape(n, s, GM_WIDTH)


def _sgu_sample(u, gv, w_s, b_s):
    n, t, _ = u.shape
    vt = gv.reshape(n, t, GM_HEADS, HEAD_DIM)
    w = jnp.tril(w_s)[:, :t, :t]
    sv = jnp.einsum('hts,bshd->bthd', w, vt) + b_s[:, :t].T[:, :, None]
    return u * sv.reshape(n, t, GM_WIDTH)


def _ffn(h, w_gate, w_up, w_down):
    return (jax.nn.silu(h @ w_gate) * (h @ w_up)) @ w_down


def _post(x, f, gate, g, b):
    return _layer_norm(ALPHA * x + gate * f, g, b)


def setup_inputs(seed: int = 0) -> dict:
    key = jax.random.key(seed)
    ks = jax.random.split(key, 24)
    f32 = jnp.float32
    wb = min(WINDOW, PAST_LEN)
    nrm = lambda k, shape: jax.random.normal(k, shape, dtype=f32)
    return {
        "x_prompt": nrm(ks[0], (BATCH, SEQ, D_MODEL)),
        "x_sample": nrm(ks[1], (DEC_BATCH, DEC_SEQ, D_MODEL)),
        "cache_k_win": nrm(ks[2], (DEPTH, DEC_BATCH, wb, KV_HEADS, HEAD_DIM)),
        "cache_v_win": nrm(ks[3], (DEPTH, DEC_BATCH, wb, KV_HEADS, HEAD_DIM)),
        "c_prompt": nrm(ks[4], (BATCH, D_MODEL)),
        "c_sample": nrm(ks[5], (DEC_BATCH, D_MODEL)),
        "w_ada": nrm(ks[6], (DEPTH, D_MODEL, 6 * D_MODEL)) * (0.5 * D_MODEL ** -0.5),
        "b_ada": nrm(ks[7], (DEPTH, 6 * D_MODEL)) * 0.02,
        "w_in": nrm(ks[8], (DEPTH, D_MODEL, IN_WIDTH)) * D_MODEL ** -0.5,
        "attn_sinks": nrm(ks[9], (DEPTH, ATT_HEADS)),
        "sgu_ln_g": 1.0 + 0.02 * nrm(ks[10], (DEPTH, GM_WIDTH)),
        "sgu_ln_b": 0.02 * nrm(ks[11], (DEPTH, GM_WIDTH)),
        "w_s": nrm(ks[12], (DEPTH, GM_HEADS, CHUNK, CHUNK)) * CHUNK ** -0.5,
        "b_s": 1.0 + 0.02 * nrm(ks[13], (DEPTH, GM_HEADS, CHUNK)),
        "w_o": nrm(ks[14], (DEPTH, MIX_WIDTH, D_MODEL)) * (MIX_WIDTH ** -0.5 * BETA),
        "ln1_g": 1.0 + 0.02 * nrm(ks[15], (DEPTH, D_MODEL)),
        "ln1_b": 0.02 * nrm(ks[16], (DEPTH, D_MODEL)),
        "w_gate": nrm(ks[17], (DEPTH, D_MODEL, D_FF)) * D_MODEL ** -0.5,
        "w_up": nrm(ks[18], (DEPTH, D_MODEL, D_FF)) * D_MODEL ** -0.5,
        "w_down": nrm(ks[19], (DEPTH, D_FF, D_MODEL)) * (D_FF ** -0.5 * BETA),
        "ln2_g": 1.0 + 0.02 * nrm(ks[20], (DEPTH, D_MODEL)),
        "ln2_b": 0.02 * nrm(ks[21], (DEPTH, D_MODEL)),
    }


def reference(x_prompt, x_sample, cache_k_win, cache_v_win, c_prompt, c_sample,
              w_ada, b_ada, w_in, attn_sinks, sgu_ln_g, sgu_ln_b, w_s, b_s, w_o,
              ln1_g, ln1_b, w_gate, w_up, w_down, ln2_g, ln2_b):
    yp, ys = x_prompt, x_sample
    pos_p = jnp.arange(yp.shape[1], dtype=jnp.int32)
    pos_s = PAST_LEN + jnp.arange(ys.shape[1], dtype=jnp.int32)
    kwp, vwp, kws, vws, sgv = [], [], [], [], []
    for l in range(DEPTH):
        mp = _adaln(c_prompt, w_ada[l], b_ada[l])
        ms = _adaln(c_sample, w_ada[l], b_ada[l])
        q, k, v, u, gv = _project(_modulate(yp, mp[0], mp[1]), w_in[l], pos_p, sgu_ln_g[l], sgu_ln_b[l])
        mix = jnp.concatenate([_attn_prompt(q, k, v, attn_sinks[l]),
                               _sgu_prompt(u, gv, w_s[l], b_s[l])], axis=-1) @ w_o[l]
        yp = _post(yp, mix, mp[2], ln1_g[l], ln1_b[l])
        kwp.append(k[:, -WINDOW:])
        vwp.append(v[:, -WINDOW:])
        yp = _post(yp, _ffn(_modulate(yp, mp[3], mp[4]), w_gate[l], w_up[l], w_down[l]),
                   mp[5], ln2_g[l], ln2_b[l])
        q, k, v, u, gv = _project(_modulate(ys, ms[0], ms[1]), w_in[l], pos_s, sgu_ln_g[l], sgu_ln_b[l])
        a, k_new, v_new = _attn_sample(q, k, v, cache_k_win[l], cache_v_win[l], attn_sinks[l])
        mix = jnp.concatenate([a, _sgu_sample(u, gv, w_s[l], b_s[l])], axis=-1) @ w_o[l]
        ys = _post(ys, mix, ms[2], ln1_g[l], ln1_b[l])
        kws.append(k_new)
        vws.append(v_new)
        sgv.append(gv)
        ys = _post(ys, _ffn(_modulate(ys, ms[3], ms[4]), w_gate[l], w_up[l], w_down[l]),
                   ms[5], ln2_g[l], ln2_b[l])
    new_k_win_prompt = jnp.stack(kwp, axis=0)
    new_v_win_prompt = jnp.stack(vwp, axis=0)
    new_k_win_sample = jnp.stack(kws, axis=0)
    new_v_win_sample = jnp.stack(vws, axis=0)
    new_sgu_v_sample = jnp.stack(sgv, axis=0)
    return (yp, ys, new_k_win_prompt, new_v_win_prompt, new_k_win_sample, new_v_win_sample, new_sgu_v_sample)
```

```cpp
#include <hip/hip_runtime.h>
#include <cstdio>
#include <cstdint>

#ifndef MK_N_LAUNCHES
#define MK_N_LAUNCHES 10
#endif
namespace pg8 {
#define PG8_LAS __attribute__((address_space(3)))
typedef unsigned short bf16_t;
typedef short bf16x8 __attribute__((ext_vector_type(8)));
typedef float f32x4 __attribute__((ext_vector_type(4)));
typedef unsigned u32x4 __attribute__((ext_vector_type(4)));
constexpr int BM = 256, BK = 64, HALF = 128, HTB = HALF * BK * 2  , STAGE_BYTES = 8 * HTB, NXCD = 8, WGM = 8;

__host__ __device__ __forceinline__ int lds_byte(int r, int c) { const int st = (r >> 4) * 2 + (c >> 5), rr = r & 15, cc = c & 31, ob = rr * 64 + cc * 2; return st * 1024 + (ob ^ (((ob >> 9) & 1) << 5)); }
__host__ __device__ __forceinline__ void stage_rc(int b, int& R, int& C) { const int st = b / 1024, sb = b % 1024, swz = sb ^ (((sb >> 9) & 1) << 5); R = (st >> 1) * 16 + swz / 64; C = (st & 1) * 32 + (swz % 64) / 2; }
__host__ __device__ __forceinline__ int perm32(int rho) { const int n = rho >> 4, i = rho & 15; return 8 * (i >> 2) + 4 * n + (i & 3); }

struct Unit { int pm, pn; };
struct Gemm { const bf16_t* A; const bf16_t* Bt; int M, N, K; };

struct StaticOrder {
    int nM, nN, nwg, G, c;
    __host__ __device__ void init(int M, int N, int G_, int c_) { nM = M / BM; nN = N / BM; nwg = nM * nN; G = G_; c = c_; }
    __host__ __device__ bool next(int i, Unit& u) const {
        const long L = (long)i * G + c; if (L >= nwg) return false;
        int wgid = (int)L; { const int q = nwg / NXCD, r = nwg % NXCD, xcd = wgid % NXCD, off = wgid / NXCD; wgid = (xcd < r ? xcd * (q + 1) : r * (q + 1) + (xcd - r) * q) + off; }
        const int nig = WGM * nN, gid = wgid / nig, fm = gid * WGM, gsz = (nM - fm) < WGM ? (nM - fm) : WGM;
        u.pm = fm + ((wgid % nig) % gsz); u.pn = (wgid % nig) / gsz; return true;
    }
    __device__ __forceinline__ void a_ready(const Unit&) const {}
    __device__ __forceinline__ void done(const Unit&) const {}
};

__device__ __forceinline__ unsigned cvt_pk_bf16(float lo, float hi) { unsigned r; asm volatile("v_cvt_pk_bf16_f32 %0, %1, %2" : "=v"(r) : "v"(lo), "v"(hi)); return r; }
typedef float f32x2 __attribute__((ext_vector_type(2)));
constexpr int EP_MP = 16384, EP_D = 1024, EP_NMOD = 6144, EP_FF = 2816;
constexpr float EP_ALPHA = 1.189207115002721f;
__device__ __forceinline__ int ep_modrow(int row) { return row < EP_MP ? (row >> 12) : 4 + ((row - EP_MP) >> 3); }
struct EpiPlainBf16 {
    static constexpr bool PERM = true, AFTER_DRAIN = false;
    bf16_t* O; int ldc;
    __device__ __forceinline__ void operator()(const f32x4 (&acc)[2][2][4][2], const Unit& u, int wr, int wc, int fr, int fq) const {
        const int row0 = u.pm * BM + wr * 64 + fr, col0 = u.pn * BM + wc * 32 + 8 * fq;
#pragma unroll
        for (int ai = 0; ai < 2; ++ai)
#pragma unroll
            for (int m = 0; m < 4; ++m) { bf16_t* rowp = O + (size_t)(row0 + ai * HALF + m * 16) * ldc + col0;
#pragma unroll
                for (int bj = 0; bj < 2; ++bj) { const f32x4 v0 = acc[ai][bj][m][0], v1 = acc[ai][bj][m][1];
                    u32x4 w; w.x = cvt_pk_bf16(v0[0], v0[1]); w.y = cvt_pk_bf16(v0[2], v0[3]); w.z = cvt_pk_bf16(v1[0], v1[1]); w.w = cvt_pk_bf16(v1[2], v1[3]);
                    *(u32x4*)(rowp + bj * HALF) = w; } }
    }
};
struct EpiResGate {
    static constexpr bool PERM = true, AFTER_DRAIN = false;
    const float* rp; const float* rs; const float* gate; float* out;
    __device__ __forceinline__ void operator()(const f32x4 (&acc)[2][2][4][2], const Unit& u, int wr, int wc, int fr, int fq) const {
        const int row0 = u.pm * BM + wr * 64 + fr, col0 = u.pn * BM + wc * 32 + 8 * fq;
#pragma unroll
        for (int ai = 0; ai < 2; ++ai)
#pragma unroll
            for (int m = 0; m < 4; ++m) { const int row = row0 + ai * HALF + m * 16;
                const float* r_ = (row < EP_MP ? rp + (size_t)row * EP_D : rs + (size_t)(row - EP_MP) * EP_D) + col0;
                const float* g_ = gate + (size_t)ep_modrow(row) * EP_NMOD + col0; float* o_ = out + (size_t)row * EP_D + col0;
#pragma unroll
                for (int bj = 0; bj < 2; ++bj)
#pragma unroll
                    for (int n = 0; n < 2; ++n) { const f32x4 rv = *(const f32x4*)(r_ + bj * HALF + 4 * n), gv = *(const f32x4*)(g_ + bj * HALF + 4 * n);
                        *(f32x4*)(o_ + bj * HALF + 4 * n) = rv * EP_ALPHA + gv * acc[ai][bj][m][n]; } }
    }
};
__device__ __forceinline__ float ep_silu(float x) { return x * __builtin_amdgcn_rcpf(1.0f + __builtin_amdgcn_exp2f(x * -1.4426950408889634f)); }
struct EpiSwiGLU {
    static constexpr bool PERM = true, AFTER_DRAIN = false;
    bf16_t* H;
    __device__ __forceinline__ void operator()(const f32x4 (&acc)[2][2][4][2], const Unit& u, int wr, int wc, int fr, int fq) const {
        const int row0 = u.pm * BM + wr * 64 + fr, col0 = u.pn * HALF + wc * 32 + 8 * fq;
#pragma unroll
        for (int ai = 0; ai < 2; ++ai)
#pragma unroll
            for (int m = 0; m < 4; ++m) { const f32x4 g0 = acc[ai][0][m][0], g1 = acc[ai][0][m][1], u0 = acc[ai][1][m][0], u1 = acc[ai][1][m][1];
                u32x4 w; w.x = cvt_pk_bf16(ep_silu(g0[0]) * u0[0], ep_silu(g0[1]) * u0[1]); w.y = cvt_pk_bf16(ep_silu(g0[2]) * u0[2], ep_silu(g0[3]) * u0[3]);
                w.z = cvt_pk_bf16(ep_silu(g1[0]) * u1[0], ep_silu(g1[1]) * u1[1]); w.w = cvt_pk_bf16(ep_silu(g1[2]) * u1[2], ep_silu(g1[3]) * u1[3]);
                *(u32x4*)(H + (size_t)(row0 + ai * HALF + m * 16) * EP_FF + col0) = w; }
    }
};
template <class Epi, class Sched, bool ALIGN_EPI = false, bool SP2 = false>
__device__ __forceinline__ void gemm_phase(PG8_LAS unsigned char* lds, const Gemm g, const Sched& S, const Epi& E) {
    const int tid = threadIdx.x, wid = __builtin_amdgcn_readfirstlane(tid >> 6), lane = tid & 63, wr = wid >> 2, wc = wid & 3, fr = lane & 15, fq = lane >> 4;
    const int K = g.K, nt = K / BK;
    unsigned voffA[2], voffB[2];
#pragma unroll
    for (int i = 0; i < 2; ++i) { int R, C; stage_rc(tid * 16 + i * 8192, R, C); const int Rb = Epi::PERM ? ((R & ~31) + perm32(R & 31)) : R;
        voffA[i] = (unsigned)(R * K + C) * 2u; voffB[i] = (unsigned)(Rb * K + C) * 2u; }
    const size_t kstep = (size_t)(BK * 2);
    const size_t hstep = (size_t)HALF * K * 2;
    const size_t tstep = 2 * hstep;
    const unsigned ldsw = (unsigned)wid * 1024u;
    const int aoff = lds_byte(wr * 64 + fr, fq * 8), boff = lds_byte(wc * 32 + fr, fq * 8);
#define PG8_SA(b, h) (((b) * 2 + (h)) * HTB)
#define PG8_SB(b, h) ((4 + (b) * 2 + (h)) * HTB)
#define PG8_STAGE(bufoff, gbase, voff) do { _Pragma("unroll") for (int _i = 0; _i < 2; ++_i) \
        __builtin_amdgcn_global_load_lds((const unsigned*)((const char*)(gbase) + (voff)[_i]), (PG8_LAS unsigned*)(lds + (bufoff) + ldsw + _i * 8192), 16, 0, 0); } while (0)
#define PG8_LDA(dst, b, h) do { _Pragma("unroll") for (int m = 0; m < 4; ++m) _Pragma("unroll") for (int k = 0; k < 2; ++k) dst[m][k] = *(const PG8_LAS bf16x8*)(lds + PG8_SA(b, h) + aoff + m * 2048 + k * 1024); } while (0)
#define PG8_LDB(dst, b, h) do { _Pragma("unroll") for (int n = 0; n < 2; ++n) _Pragma("unroll") for (int k = 0; k < 2; ++k) dst[n][k] = *(const PG8_LAS bf16x8*)(lds + PG8_SB(b, h) + boff + n * 2048 + k * 1024); } while (0)
#define PG8_MMA(ai, bj, At, Bt) do { __builtin_amdgcn_s_setprio(1); _Pragma("unroll") for (int m = 0; m < 4; ++m) _Pragma("unroll") for (int n = 0; n < 2; ++n) _Pragma("unroll") for (int k = 0; k < 2; ++k) \
        acc[ai][bj][m][n] = __builtin_amdgcn_mfma_f32_16x16x32_bf16(Bt[n][k], At[m][k], acc[ai][bj][m][n], 0, 0, 0); __builtin_amdgcn_s_setprio(0); } while (0)
#define PG8_WAIT_V(n) asm volatile("s_waitcnt vmcnt(" #n ")" ::: "memory")
#define PG8_WAIT_L(n) asm volatile("s_waitcnt lgkmcnt(" #n ")" ::: "memory")
#define PG8_BAR __builtin_amdgcn_s_barrier()
#define PG8_SCHED __builtin_amdgcn_sched_barrier(0)
    Unit cur, nxt; int ui = 0;
    if (!S.next(0, cur)) return;
    f32x4 acc[2][2][4][2];
#pragma unroll
    for (int a = 0; a < 2; ++a)
#pragma unroll
        for (int b = 0; b < 2; ++b)
#pragma unroll
            for (int m = 0; m < 4; ++m)
#pragma unroll
                for (int n = 0; n < 2; ++n) acc[a][b][m][n] = (f32x4){0.f, 0.f, 0.f, 0.f};
    bf16x8 At[4][2], B0[2][2], B1[2][2];
    const char* cA = (const char*)g.A + (size_t)cur.pm * tstep; const char* cB = (const char*)g.Bt + (size_t)cur.pn * tstep;
    S.a_ready(cur);
    if constexpr (SP2) {
        PG8_STAGE(PG8_SB(0, 0), cB, voffB); PG8_STAGE(PG8_SB(0, 1), cB + hstep, voffB); PG8_STAGE(PG8_SA(0, 0), cA, voffA); PG8_STAGE(PG8_SA(0, 1), cA + hstep, voffA);
        if (wr == 1) PG8_BAR;
        PG8_WAIT_V(2); PG8_BAR;
        PG8_STAGE(PG8_SB(1, 0), cB + kstep, voffB); PG8_STAGE(PG8_SA(1, 0), cA + kstep, voffA); PG8_STAGE(PG8_SB(1, 1), cB + hstep + kstep, voffB);
        PG8_WAIT_V(6); PG8_BAR;
    } else {
        PG8_STAGE(PG8_SB(0, 0), cB, voffB); PG8_STAGE(PG8_SA(0, 0), cA, voffA); PG8_STAGE(PG8_SB(0, 1), cB + hstep, voffB); PG8_STAGE(PG8_SA(0, 1), cA + hstep, voffA);
        if (wr == 1) PG8_BAR;
        PG8_WAIT_V(4); PG8_BAR;
        PG8_STAGE(PG8_SB(1, 0), cB + kstep, voffB); PG8_STAGE(PG8_SA(1, 0), cA + kstep, voffA); PG8_STAGE(PG8_SB(1, 1), cB + hstep + kstep, voffB);
        PG8_WAIT_V(6); PG8_BAR;
    }
    for (;;) {
        const bool has_next = S.next(ui + 1, nxt);
        const char* nA = has_next ? (const char*)g.A + (size_t)nxt.pm * tstep : cA; const char* nB = has_next ? (const char*)g.Bt + (size_t)nxt.pn * tstep : cB;
        for (int t = 0; t < nt; t += 2) {
            const bool last = (t == nt - 2);
            const char* a1 = cA + (size_t)(t + 1) * kstep;
            const char* a2 = last ? nA : cA + (size_t)(t + 2) * kstep; const char* b2 = last ? nB : cB + (size_t)(t + 2) * kstep;
            const char* a3 = a2 + kstep; const char* b3 = b2 + kstep;
            if (last && has_next) S.a_ready(nxt);
            if constexpr (SP2) {
            PG8_LDB(B0, 0, 0); PG8_LDB(B1, 0, 1); PG8_SCHED; PG8_LDA(At, 0, 0); PG8_STAGE(PG8_SA(1, 1), a1 + hstep, voffA);
            PG8_WAIT_V(8); PG8_WAIT_L(0); PG8_BAR; PG8_MMA(0, 0, At, B0); PG8_MMA(0, 1, At, B1); PG8_BAR; PG8_SCHED;
            PG8_LDA(At, 0, 1); PG8_STAGE(PG8_SB(0, 0), b2, voffB); PG8_STAGE(PG8_SB(0, 1), b2 + hstep, voffB); PG8_STAGE(PG8_SA(0, 0), a2, voffA);
            PG8_WAIT_V(8); PG8_WAIT_L(0); PG8_BAR; PG8_MMA(1, 0, At, B0); PG8_MMA(1, 1, At, B1); PG8_BAR; PG8_SCHED;
            PG8_LDB(B0, 1, 0); PG8_LDB(B1, 1, 1); PG8_SCHED; PG8_LDA(At, 1, 0); PG8_STAGE(PG8_SA(0, 1), a2 + hstep, voffA);
            PG8_WAIT_V(8); PG8_WAIT_L(0); PG8_BAR; PG8_MMA(0, 0, At, B0); PG8_MMA(0, 1, At, B1); PG8_BAR; PG8_SCHED;
            PG8_LDA(At, 1, 1); PG8_STAGE(PG8_SB(1, 0), b3, voffB); PG8_STAGE(PG8_SB(1, 1), b3 + hstep, voffB); PG8_STAGE(PG8_SA(1, 0), a3, voffA);
            PG8_WAIT_V(8); PG8_WAIT_L(0); PG8_BAR; PG8_MMA(1, 0, At, B0); PG8_MMA(1, 1, At, B1); PG8_BAR; PG8_SCHED;
            } else {
            PG8_LDB(B0, 0, 0); PG8_SCHED; PG8_LDA(At, 0, 0); PG8_STAGE(PG8_SA(1, 1), a1 + hstep, voffA);
            PG8_WAIT_L(8); PG8_BAR; PG8_WAIT_L(0); PG8_MMA(0, 0, At, B0); PG8_BAR; PG8_SCHED;
            PG8_LDB(B1, 0, 1); PG8_STAGE(PG8_SB(0, 0), b2, voffB);
            PG8_BAR; PG8_WAIT_L(0); PG8_MMA(0, 1, At, B1); PG8_BAR;
            PG8_LDA(At, 0, 1); PG8_STAGE(PG8_SA(0, 0), a2, voffA);
            PG8_BAR; PG8_WAIT_L(0); PG8_MMA(1, 0, At, B0); PG8_BAR; PG8_SCHED;
            PG8_STAGE(PG8_SB(0, 1), b2 + hstep, voffB);
            PG8_WAIT_V(6); PG8_BAR; PG8_MMA(1, 1, At, B1); PG8_BAR;
            PG8_LDB(B0, 1, 0); PG8_SCHED; PG8_LDA(At, 1, 0); PG8_STAGE(PG8_SA(0, 1), a2 + hstep, voffA);
            PG8_WAIT_L(8); PG8_BAR; PG8_WAIT_L(0); PG8_MMA(0, 0, At, B0); PG8_BAR; PG8_SCHED;
            PG8_LDB(B1, 1, 1); PG8_STAGE(PG8_SB(1, 0), b3, voffB);
            PG8_BAR; PG8_WAIT_L(0); PG8_MMA(0, 1, At, B1); PG8_BAR;
            PG8_LDA(At, 1, 1); PG8_STAGE(PG8_SA(1, 0), a3, voffA);
            PG8_BAR; PG8_WAIT_L(0); PG8_MMA(1, 0, At, B0); PG8_BAR; PG8_SCHED;
            PG8_STAGE(PG8_SB(1, 1), b3 + hstep, voffB);
            PG8_WAIT_V(6); PG8_BAR; PG8_MMA(1, 1, At, B1); PG8_BAR;
            }
        }
        if constexpr (ALIGN_EPI) { if (wr == 0) PG8_BAR; }
        if constexpr (!Epi::AFTER_DRAIN) { E(acc, cur, wr, wc, fr, fq); S.done(cur); }
        if (!has_next) break;
#pragma unroll
        for (int a = 0; a < 2; ++a)
#pragma unroll
            for (int b = 0; b < 2; ++b)
#pragma unroll
                for (int m = 0; m < 4; ++m)
#pragma unroll
                    for (int n = 0; n < 2; ++n) acc[a][b][m][n] = (f32x4){0.f, 0.f, 0.f, 0.f};
        cur = nxt; cA = nA; cB = nB; ++ui;
        if constexpr (ALIGN_EPI) { if (wr == 1) PG8_BAR; }
    }
    PG8_WAIT_V(0);
    if constexpr (!ALIGN_EPI) { if (wr == 0) PG8_BAR; }
    PG8_BAR;
    if constexpr (Epi::AFTER_DRAIN) { E.fused(acc, cur, wr, wc, fr, fq, lds, wid, lane); S.done(cur); }
#undef PG8_SA
#undef PG8_SB
#undef PG8_STAGE
#undef PG8_LDA
#undef PG8_LDB
#undef PG8_MMA
#undef PG8_WAIT_V
#undef PG8_WAIT_L
#undef PG8_BAR
#undef PG8_SCHED
}
}

#ifndef PG8_SP2
#define PG8_SP2 true
#endif
#ifndef PG8_ALIGN
#define PG8_ALIGN true
#endif
#define GAS __attribute__((address_space(1)))
#define LAS __attribute__((address_space(3)))
typedef unsigned short bf16;
typedef unsigned v4u __attribute__((ext_vector_type(4)));
typedef float f32x4 __attribute__((ext_vector_type(4)));
typedef short bf16x8 __attribute__((ext_vector_type(8)));
typedef GAS unsigned gu32;
typedef GAS unsigned long long gu64;
#define RLX_AGENT __ATOMIC_RELAXED, __HIP_MEMORY_SCOPE_AGENT
#define LDS_WAIT() asm volatile("s_waitcnt lgkmcnt(0)" ::: "memory")
#define VM_WAIT() asm volatile("s_waitcnt vmcnt(0)" ::: "memory")
__device__ __forceinline__ unsigned long long rt() { return __builtin_amdgcn_s_memrealtime(); }
__device__ __forceinline__ unsigned f2bf(float f) { unsigned u = __builtin_bit_cast(unsigned, f); return (u + 0x7fffu + ((u >> 16) & 1u)) >> 16; }
__device__ __forceinline__ unsigned pk2(float lo, float hi) { return f2bf(lo) | (f2bf(hi) << 16); }

#define XB_TMO      128
#define XB_XCNT(j)  (256  + 64 * (j))
#define XB_XSUB(j)  (1280 + 64 * (j))
#define XB_XGEN(j)  (2304 + 64 * (j))
#define XB_TOP      3328
#define XB_TOPGEN   3392
#define XCD_BAR_WORDS 3456
#define XB_SPIN_CAP (1u << 18)

__device__ __forceinline__ unsigned xb_ld(unsigned* p)              { return __hip_atomic_load(p, __ATOMIC_RELAXED, __HIP_MEMORY_SCOPE_AGENT); }
__device__ __forceinline__ unsigned xb_add(unsigned* p, unsigned v) { return __hip_atomic_fetch_add(p, v, __ATOMIC_RELAXED, __HIP_MEMORY_SCOPE_AGENT); }
__device__ __forceinline__ unsigned xb_xcc_id() { return (unsigned)__builtin_amdgcn_s_getreg((3 << 11) | 20) & 0xFu; }
#define XB_SPIN(cond, bar) do { unsigned _sp = 0; while (cond) { __builtin_amdgcn_s_sleep(1); \
    if ((++_sp & 255u) == 0u) { if (xb_ld(&(bar)[XB_TMO])) break; if (_sp > XB_SPIN_CAP) { atomicAdd(&(bar)[XB_TMO], 1u); break; } } } } while (0)

struct XcdBarrier {
    unsigned* bar; unsigned x;
    volatile LAS unsigned* st;
};

__device__ __forceinline__ XcdBarrier xcd_barrier_post(unsigned* bar, volatile LAS unsigned* st) {
    XcdBarrier b; b.bar = bar; b.x = xb_xcc_id(); b.st = st;
    if (threadIdx.x == 0) (void)xb_add(&bar[XB_XCNT(b.x)], 1u);
    return b;
}
__device__ __forceinline__ void xcd_barrier_complete(unsigned* bar, unsigned x, unsigned& nloc, unsigned& nx) {
    const unsigned G = gridDim.x * gridDim.y * gridDim.z;
    unsigned sum, cnt, mine, sp = 0u;
    for (;;) {
        sum = 0u; cnt = 0u; mine = 0u;
#pragma unroll
        for (unsigned j = 0; j < 16; ++j) { const unsigned c = xb_ld(&bar[XB_XCNT(j)]); sum += c; cnt += (c > 0u) ? 1u : 0u; mine = (j == x) ? c : mine; }
        if (sum == G) break;
        __builtin_amdgcn_s_sleep(1);
        if ((++sp & 255u) == 0u) { if (xb_ld(&bar[XB_TMO])) break; if (sp > XB_SPIN_CAP) { atomicAdd(&bar[XB_TMO], 1u); break; } }
    }
    nloc = mine > 0u ? mine : 1u; nx = cnt > 0u ? cnt : 1u;
}

__device__ __forceinline__ void xcd_barrier(const XcdBarrier& b) {
    asm volatile("s_waitcnt vmcnt(0)" ::: "memory");
    __syncthreads();
    if (threadIdx.x == 0) {
        unsigned* bar = b.bar;
        __builtin_amdgcn_s_waitcnt(0);
        unsigned nloc = b.st[0], nx = b.st[1];
        if (nloc == 0u) { xcd_barrier_complete(bar, b.x, nloc, nx); b.st[0] = nloc; b.st[1] = nx; }
        const unsigned old = xb_add(&bar[XB_XSUB(b.x)], 1u);
        const unsigned gen = old / nloc;
        if (old + 1u == (gen + 1u) * nloc) {
            __builtin_amdgcn_fence(__ATOMIC_RELEASE, "agent");
            asm volatile("s_waitcnt vmcnt(0)" ::: "memory");
            const unsigned og = xb_add(&bar[XB_TOP], 1u);
            const unsigned tg = og / nx;
            if (og + 1u == (tg + 1u) * nx) xb_add(&bar[XB_TOPGEN], 1u);
            else XB_SPIN(xb_ld(&bar[XB_TOPGEN]) == tg, bar);
            __builtin_amdgcn_fence(__ATOMIC_ACQUIRE, "agent");
            xb_add(&bar[XB_XGEN(b.x)], 1u);
            asm volatile("s_waitcnt vmcnt(0)" ::: "memory");
        } else {
            XB_SPIN(xb_ld(&bar[XB_XGEN(b.x)]) == gen, bar);
            __builtin_amdgcn_fence(__ATOMIC_ACQUIRE, "agent");
            asm volatile("s_waitcnt vmcnt(0)" ::: "memory");
        }
    }
    __syncthreads();
}
constexpr int NWAVES = 8;
constexpr int N_LAUNCHES = MK_N_LAUNCHES;
constexpr int PER_PHASE = 10;
constexpr int D = 1024, BATCH = 4, SEQ = 4096, DECB = 128, DECS = 8, PAST = 16384;
constexpr int MP = BATCH * SEQ, MS = DECB * DECS, M = MP + MS;
constexpr int INW = 1792, FF = 2816, NGU = 2 * FF, NMOD = 6144, NMODR = 132, NMODR_PAD = 144;
constexpr int ZQ = 0, ZK = 512, ZV = 640, ZU = 768, ZG = 1280;
constexpr float LN_EPS = 1e-5f, LOG2E = 1.4426950408889634f, QSCALE = 0.125f * 1.4426950408889634f;
constexpr int NIN = 22;
constexpr size_t O_YP = 0, O_YS = 16777216, O_KWP = 17825792, O_VWP = 17891328, O_KWS = 17956864, O_VWS = 20054016, O_SGV = 22151168, O_END = 22675456;
constexpr size_t MiB = 1u << 20;
constexpr size_t WS_CTL = 0, CTL_ZERO_BYTES = 1 * MiB;
constexpr size_t WS_MOD = 1 * MiB, WS_SC = 5 * MiB, WS_ROPE = 6 * MiB, WS_WST = 7 * MiB;
constexpr size_t WS_WIN = 8 * MiB, WS_WO = 12 * MiB, WS_WGU = 14 * MiB, WS_WD = 26 * MiB;
constexpr size_t WS_XN = 32 * MiB, WS_Z = 66 * MiB, WS_MIX = 126 * MiB, WS_H = 66 * MiB, WS_Y1 = 160 * MiB, WS_END = 228 * MiB;
static_assert(WS_MOD + (size_t)NMODR_PAD * NMOD * 4 <= WS_SC && WS_WIN + (size_t)INW * D * 2 <= WS_WO && WS_WGU + (size_t)NGU * D * 2 <= WS_WD && WS_WD + (size_t)D * FF * 2 <= WS_XN, "ws map 1");
static_assert(WS_XN + (size_t)M * D * 2 <= WS_Z && WS_Z + (size_t)M * INW * 2 <= WS_MIX && WS_MIX + (size_t)M * D * 2 <= WS_Y1 && WS_H + (size_t)M * FF * 2 <= WS_Y1 && WS_Y1 + (size_t)M * D * 4 <= WS_END, "ws map 2");
constexpr int CW_BAR = 4096;
constexpr int RING_OFF = 0, RING_BYTES = 131072, LDSCTL_OFF = RING_BYTES, MISC_OFF = LDSCTL_OFF + 320, LDS_BYTES = 147456;

typedef float f32x16 __attribute__((ext_vector_type(16)));
typedef short s16x4 __attribute__((ext_vector_type(4)));
typedef float f32x2_t __attribute__((ext_vector_type(2))); typedef __bf16 bf16x2_t __attribute__((ext_vector_type(2)));
__device__ __forceinline__ unsigned cvtpk(float lo, float hi) { f32x2_t v = {lo, hi}; bf16x2_t b = __builtin_convertvector(v, bf16x2_t); return __builtin_bit_cast(unsigned, b); }
#define MFMA32(a, b, c) __builtin_amdgcn_mfma_f32_32x32x16_bf16((a), (b), (c), 0, 0, 0)
#define MFMA16(a, b, c) __builtin_amdgcn_mfma_f32_16x16x32_bf16((a), (b), (c), 0, 0, 0)
__device__ __forceinline__ int crow(int r, int hi) { return (r & 3) + 8 * (r >> 2) + 4 * hi; }
__device__ __forceinline__ float bf2f(unsigned short b) { return __uint_as_float((unsigned)b << 16); }
__device__ __forceinline__ float bflo(unsigned w) { return __uint_as_float(w << 16); }
__device__ __forceinline__ float bfhi(unsigned w) { return __uint_as_float(w & 0xffff0000u); }
__device__ __forceinline__ void unpack8(const v4u w, float (&x)[8]) { x[0] = bflo(w.x); x[1] = bfhi(w.x); x[2] = bflo(w.y); x[3] = bfhi(w.y); x[4] = bflo(w.z); x[5] = bfhi(w.z); x[6] = bflo(w.w); x[7] = bfhi(w.w); }
__device__ __forceinline__ v4u pack8(const float (&x)[8]) { v4u w; w.x = cvtpk(x[0], x[1]); w.y = cvtpk(x[2], x[3]); w.z = cvtpk(x[4], x[5]); w.w = cvtpk(x[6], x[7]); return w; }
__device__ __forceinline__ float fexp2(float x) { return __builtin_amdgcn_exp2f(x); }
__device__ __forceinline__ float gelu_tanh(float x) {
    const float u = 0.7978845608028654f * (x + 0.044715f * x * x * x);
    return x * __builtin_amdgcn_rcpf(1.0f + fexp2(u * (-2.0f * LOG2E)));
}
__device__ __forceinline__ float silu_f(float x) { return x * __builtin_amdgcn_rcpf(1.0f + fexp2(x * -LOG2E)); }
__device__ __forceinline__ float wave_sum(float v) {
#pragma unroll
    for (int o = 1; o < 64; o <<= 1) v += __shfl_xor(v, o);
    return v;
}
__device__ __forceinline__ int modrow(int row) { return row < MP ? (row >> 12) : 4 + ((row - MP) >> 3); }

struct Args { const float* in[NIN]; float* out; unsigned char* ws; int ph_lo, ph_hi, li, pad; };
struct Frame { LAS unsigned char* lds; volatile LAS unsigned* MISC; gu32* ctl; int tid, lane, wave, vcu, G; };

__device__ __forceinline__ void p0_transpose_item(const float* W, int K, int N, bf16* WT, int row_off, LAS float* scr, int kb, int n0, int lane) {
    const int k0 = 64 * kb;
#pragma unroll 8
    for (int i = 0; i < 32; ++i) { const int kk = 2 * i + (lane >> 5); scr[kk * 33 + (lane & 31)] = W[(size_t)(k0 + kk) * N + n0 + (lane & 31)]; }
    LDS_WAIT(); asm volatile("" ::: "memory");
    const int c = lane & 7;
#pragma unroll
    for (int j = 0; j < 4; ++j) { const int n = (lane >> 3) + 8 * j; const LAS float* s = scr + (8 * c) * 33 + n;
        v4u o; o.x = pk2(s[0 * 33], s[1 * 33]); o.y = pk2(s[2 * 33], s[3 * 33]); o.z = pk2(s[4 * 33], s[5 * 33]); o.w = pk2(s[6 * 33], s[7 * 33]);
        *(GAS v4u*)(WT + (size_t)(row_off + n0 + n) * K + k0 + 8 * c) = o; }
    LDS_WAIT(); asm volatile("" ::: "memory");
}
__device__ __forceinline__ void phase_prep(const Args& a, Frame& F) {
    unsigned char* ws = a.ws;
    const int gw = F.vcu * NWAVES + F.wave, NGW = F.G * NWAVES, gt = gw * 64 + F.lane, NGT = NGW * 64;
    { bf16* SC = (bf16*)(ws + WS_SC);
      for (int r = gw; r < NMODR_PAD; r += NGW) {
          const float* src = r < 4 ? a.in[4] + (size_t)r * D : a.in[5] + (size_t)(r < NMODR ? r - 4 : 0) * D;
#pragma unroll
          for (int j = 0; j < 4; ++j) { f32x4 v = ((const f32x4*)src)[F.lane + 64 * j];
              if (r >= NMODR) v = (f32x4){0.f, 0.f, 0.f, 0.f};
              ((unsigned long long*)(SC + (size_t)r * D))[F.lane + 64 * j] = (unsigned long long)pk2(silu_f(v.x), silu_f(v.y)) | ((unsigned long long)pk2(silu_f(v.z), silu_f(v.w)) << 32); } } }
    { float* ROPE = (float*)(ws + WS_ROPE);
      for (int e = gt; e < 4104 * 8; e += NGT) { const int idx = e >> 3, i = e & 7; const int pos = idx < 4096 ? idx : PAST + idx - 4096;
          const float invf = i == 0 ? 1.0f : i == 1 ? 0.1939227432012558f : i == 2 ? 0.03760603070259094f : i == 3 ? 0.007292664609849453f : i == 4 ? 0.0014142135623842478f : i == 5 ? 0.00027424818836152554f : i == 6 ? 5.318296098266728e-05f : 1.0313386155758053e-05f;
          const float ang = (float)pos * invf;
          const double rev = (double)ang * 0.15915494309189535; const float fr = (float)(rev - __builtin_rint(rev));
          ROPE[idx * 16 + i] = __builtin_amdgcn_cosf(fr); ROPE[idx * 16 + 8 + i] = __builtin_amdgcn_sinf(fr); } }
    { bf16* WST = (bf16*)(ws + WS_WST);
      for (int e = gt; e < 8 * 128 * 128 / 4; e += NGT) { const int idx = e * 4, s = idx & 127, t = (idx >> 7) & 127; const f32x4 v = ((const f32x4*)a.in[12])[e];
          ((unsigned long long*)WST)[e] = (unsigned long long)pk2(s <= t ? v.x : 0.f, s + 1 <= t ? v.y : 0.f) | ((unsigned long long)pk2(s + 2 <= t ? v.z : 0.f, s + 3 <= t ? v.w : 0.f) << 32); } }
    { LAS float* scr = (LAS float*)(F.lds + RING_OFF + F.wave * 16384);
      constexpr int I_IN = (D / 64) * (INW / 32), I_O = (D / 64) * (D / 32), I_G = (D / 64) * (FF / 32), I_D = (FF / 64) * (D / 32);
      constexpr int NITEMS = I_IN + I_O + 2 * I_G + I_D;
      for (int it = gw; it < NITEMS; it += NGW) {
          int r = it;
          if (r < I_IN) { p0_transpose_item(a.in[8], D, INW, (bf16*)(ws + WS_WIN), 0, scr, r / (INW / 32), 32 * (r % (INW / 32)), F.lane); continue; } r -= I_IN;
          if (r < I_O) { p0_transpose_item(a.in[14], D, D, (bf16*)(ws + WS_WO), 0, scr, r / (D / 32), 32 * (r % (D / 32)), F.lane); continue; } r -= I_O;
          if (r < 2 * I_G) { const int up = r >= I_G; if (up) r -= I_G; const int n0 = 32 * (r % (FF / 32)); const int rowbase = 256 * (n0 >> 7) + (n0 & 127) + (up ? 128 : 0);
              p0_transpose_item(up ? a.in[18] : a.in[17], D, FF, (bf16*)(ws + WS_WGU), rowbase - n0, scr, r / (FF / 32), n0, F.lane); continue; } r -= 2 * I_G;
          p0_transpose_item(a.in[19], FF, D, (bf16*)(ws + WS_WD), 0, scr, r / (D / 32), 32 * (r % (D / 32)), F.lane);
      } }
    { constexpr int PER_B = 120 * 128 / 4, PER_T = DECB * PER_B;
      for (int e = gt; e < 2 * PER_T; e += NGT) { const int tsel = e >= PER_T, rem = e - tsel * PER_T, b = rem / PER_B, q = rem % PER_B;
          const f32x4 v = *(const f32x4*)((tsel ? a.in[3] : a.in[2]) + (size_t)b * 16384 + 1024 + q * 4);
          *(f32x4*)(a.out + (tsel ? O_VWS : O_KWS) + (size_t)b * 16384 + q * 4) = v; } }
}

__device__ __forceinline__ void phase_ada(const Args& a, Frame& F) {
    const bf16* SC = (const bf16*)(a.ws + WS_SC); const float* W = a.in[6]; const float* bias = a.in[7]; float* MOD = (float*)(a.ws + WS_MOD);
    LAS float* part = (LAS float*)(F.lds + RING_OFF);
    const int kw = F.wave >> 1, nt = F.wave & 1, fr = F.lane & 15, kq = F.lane >> 4;
    for (int u = F.vcu; u < NMOD / 32; u += F.G) {
        const int n0 = u * 32 + nt * 16;
        f32x4 acc[9];
#pragma unroll
        for (int i = 0; i < 9; ++i) acc[i] = (f32x4){0.f, 0.f, 0.f, 0.f};
#pragma unroll 2
        for (int ks = 0; ks < 8; ++ks) {
            const int k0 = kw * 256 + ks * 32 + kq * 8;
            float w[8];
#pragma unroll
            for (int j = 0; j < 8; ++j) w[j] = W[(size_t)(k0 + j) * NMOD + n0 + fr];
            const bf16x8 bfr = __builtin_bit_cast(bf16x8, pack8(w));
#pragma unroll
            for (int mt = 0; mt < 9; ++mt) { const bf16x8 av = *(const bf16x8*)(SC + (size_t)(mt * 16 + fr) * D + k0); acc[mt] = MFMA16(av, bfr, acc[mt]); }
        }
#pragma unroll
        for (int mt = 0; mt < 9; ++mt)
#pragma unroll
            for (int r = 0; r < 4; ++r) part[(kw * NMODR_PAD + mt * 16 + 4 * kq + r) * 32 + nt * 16 + fr] = acc[mt][r];
        __syncthreads();
        for (int o = F.tid; o < NMODR * 32; o += NWAVES * 64) { const int m = o >> 5, n = o & 31;
            const float s = (part[(0 * NMODR_PAD + m) * 32 + n] + part[(1 * NMODR_PAD + m) * 32 + n]) + (part[(2 * NMODR_PAD + m) * 32 + n] + part[(3 * NMODR_PAD + m) * 32 + n]);
            MOD[(size_t)m * NMOD + u * 32 + n] = s + bias[u * 32 + n]; }
        __syncthreads();
    }
}

__device__ __forceinline__ void row_stats(const f32x4 (&v)[4], float& mean, float& rstd) {
    float s = 0.f;
#pragma unroll
    for (int j = 0; j < 4; ++j) s += (v[j].x + v[j].y) + (v[j].z + v[j].w);
    mean = wave_sum(s) * (1.f / D); float q = 0.f;
#pragma unroll
    for (int j = 0; j < 4; ++j) { const f32x4 d = v[j] - mean; q += (d.x * d.x + d.y * d.y) + (d.z * d.z + d.w * d.w); }
    rstd = 1.0f / sqrtf(wave_sum(q) * (1.f / D) + LN_EPS);
}
__device__ __forceinline__ void phase_xn(const Args& a, Frame& F) {
    const float* MOD = (const float*)(a.ws + WS_MOD); bf16* XN = (bf16*)(a.ws + WS_XN);
    const int gw = F.vcu * NWAVES + F.wave, NGW = F.G * NWAVES;
    for (int row = gw; row < M; row += NGW) {
        const float* xr = row < MP ? a.in[0] + (size_t)row * D : a.in[1] + (size_t)(row - MP) * D;
        const float* mr = MOD + (size_t)modrow(row) * NMOD;
        f32x4 v[4];
#pragma unroll
        for (int j = 0; j < 4; ++j) v[j] = ((const f32x4*)xr)[F.lane + 64 * j];
        float mean, rstd; row_stats(v, mean, rstd);
#pragma unroll
        for (int j = 0; j < 4; ++j) { const int c4 = F.lane + 64 * j; const f32x4 sh = ((const f32x4*)mr)[c4], sc = ((const f32x4*)(mr + D))[c4];
            const f32x4 o = (v[j] - mean) * rstd * (sc + 1.0f) + sh;
            ((unsigned long long*)(XN + (size_t)row * D))[c4] = (unsigned long long)cvtpk(o.x, o.y) | ((unsigned long long)cvtpk(o.z, o.w) << 32); }
    }
}
__device__ __forceinline__ void phase_ln1(const Args& a, Frame& F) {
    const float* MOD = (const float*)(a.ws + WS_MOD); bf16* XN = (bf16*)(a.ws + WS_XN); float* Y1 = (float*)(a.ws + WS_Y1);
    const float* g1 = a.in[15]; const float* b1 = a.in[16];
    const int gw = F.vcu * NWAVES + F.wave, NGW = F.G * NWAVES;
    for (int row = gw; row < M; row += NGW) {
        const float* tr = a.out + (size_t)row * D; const float* mr = MOD + (size_t)modrow(row) * NMOD;
        f32x4 v[4];
#pragma unroll
        for (int j = 0; j < 4; ++j) v[j] = ((const f32x4*)tr)[F.lane + 64 * j];
        float mean, rstd; row_stats(v, mean, rstd);
#pragma unroll
        for (int j = 0; j < 4; ++j) { const int c4 = F.lane + 64 * j; v[j] = (v[j] - mean) * rstd * ((const f32x4*)g1)[c4] + ((const f32x4*)b1)[c4]; ((f32x4*)(Y1 + (size_t)row * D))[c4] = v[j]; }
        row_stats(v, mean, rstd);
#pragma unroll
        for (int j = 0; j < 4; ++j) { const int c4 = F.lane + 64 * j; const f32x4 sh = ((const f32x4*)(mr + 3 * D))[c4], sc = ((const f32x4*)(mr + 4 * D))[c4];
            const f32x4 o = (v[j] - mean) * rstd * (sc + 1.0f) + sh;
            ((unsigned long long*)(XN + (size_t)row * D))[c4] = (unsigned long long)cvtpk(o.x, o.y) | ((unsigned long long)cvtpk(o.z, o.w) << 32); }
    }
}
__device__ __forceinline__ void phase_ln2(const Args& a, Frame& F) {
    const float* g2 = a.in[20]; const float* b2 = a.in[21];
    const int gw = F.vcu * NWAVES + F.wave, NGW = F.G * NWAVES;
    for (int row = gw; row < M; row += NGW) {
        float* tr = a.out + (size_t)row * D;
        f32x4 v[4];
#pragma unroll
        for (int j = 0; j < 4; ++j) v[j] = ((const f32x4*)tr)[F.lane + 64 * j];
        float mean, rstd; row_stats(v, mean, rstd);
#pragma unroll
        for (int j = 0; j < 4; ++j) { const int c4 = F.lane + 64 * j; ((f32x4*)tr)[c4] = (v[j] - mean) * rstd * ((const f32x4*)g2)[c4] + ((const f32x4*)b2)[c4]; }
    }
}

__device__ __forceinline__ void rot8(float (&x)[8], const float (&xp)[8], const float* rp, int hi) {
    const f32x4 c0 = *(const f32x4*)rp, c1 = *(const f32x4*)(rp + 4), s0 = *(const f32x4*)(rp + 8), s1 = *(const f32x4*)(rp + 12);
    const float c[8] = {c0.x, c0.y, c0.z, c0.w, c1.x, c1.y, c1.z, c1.w}, s[8] = {s0.x, s0.y, s0.z, s0.w, s1.x, s1.y, s1.z, s1.w};
#pragma unroll
    for (int j = 0; j < 8; ++j) x[j] = hi == 0 ? x[j] * c[j] - xp[j] * s[j] : x[j] * c[j] + xp[j] * s[j];
}
__device__ __forceinline__ void load_q(const bf16* qp  , const float* rp, int hi, bf16x8 (&qf)[4]) {
    v4u raw[4];
#pragma unroll
    for (int d0 = 0; d0 < 4; ++d0) raw[d0] = *(const v4u*)(qp + d0 * 16);
    float x[8], xp[8]; unpack8(raw[0], x);
#pragma unroll
    for (int j = 0; j < 8; ++j) xp[j] = __shfl_xor(x[j], 32);
    rot8(x, xp, rp, hi);
#pragma unroll
    for (int j = 0; j < 8; ++j) x[j] *= QSCALE;
    qf[0] = __builtin_bit_cast(bf16x8, pack8(x));
#pragma unroll
    for (int d0 = 1; d0 < 4; ++d0) { unpack8(raw[d0], x);
#pragma unroll
        for (int j = 0; j < 8; ++j) x[j] *= QSCALE;
        qf[d0] = __builtin_bit_cast(bf16x8, pack8(x)); }
}
__device__ __forceinline__ void softmax5(f32x16 (&st)[5], float sk, bf16x8 (&pf)[5][2]) {
    float m = sk;
#pragma unroll
    for (int t = 0; t < 5; ++t)
#pragma unroll
        for (int r = 0; r < 16; ++r) m = fmaxf(m, st[t][r]);
    m = fmaxf(m, __shfl_xor(m, 32));
    float sum = 0.f;
#pragma unroll
    for (int t = 0; t < 5; ++t)
#pragma unroll
        for (int r = 0; r < 16; ++r) { const float p = fexp2(st[t][r] - m); st[t][r] = p; sum += p; }
    sum += __shfl_xor(sum, 32);
    sum += fexp2(sk - m);
    const float inv = 1.0f / sum;
#pragma unroll
    for (int t = 0; t < 5; ++t)
#pragma unroll
        for (int s2 = 0; s2 < 2; ++s2) { v4u w;
            w.x = cvtpk(st[t][8 * s2 + 0] * inv, st[t][8 * s2 + 1] * inv); w.y = cvtpk(st[t][8 * s2 + 2] * inv, st[t][8 * s2 + 3] * inv);
            w.z = cvtpk(st[t][8 * s2 + 4] * inv, st[t][8 * s2 + 5] * inv); w.w = cvtpk(st[t][8 * s2 + 6] * inv, st[t][8 * s2 + 7] * inv);
            pf[t][s2] = __builtin_bit_cast(bf16x8, w); }
}
constexpr int KS_PITCH = 144, VT_PITCH = 520, KS_BYTES = 256 * KS_PITCH;
__device__ __forceinline__ void attn_prompt_unit(const Args& a, Frame& F, int b, int nb, int kvh) {
    const bf16* Z = (const bf16*)(a.ws + WS_Z); const float* ROPE = (const float*)(a.ws + WS_ROPE); bf16* MIX = (bf16*)(a.ws + WS_MIX);
    LAS unsigned char* KS = F.lds + RING_OFF; LAS unsigned char* VT = F.lds + RING_OFF + KS_BYTES;
    {
        const int kv = F.tid >> 1, half = F.tid & 1; const int p = nb * 128 - 128 + kv, pc = p < 0 ? 0 : p;
        const bf16* zr = Z + ((size_t)b * SEQ + pc) * INW + kvh * 64 + half * 32;
        v4u kq[4], vq[4];
#pragma unroll
        for (int i = 0; i < 4; ++i) { kq[i] = *(const v4u*)(zr + ZK + i * 8); vq[i] = *(const v4u*)(zr + ZV + i * 8); }
        float kf[32], vf[32];
#pragma unroll
        for (int i = 0; i < 4; ++i) { float t8[8]; unpack8(kq[i], t8);
#pragma unroll
            for (int j = 0; j < 8; ++j) kf[i * 8 + j] = t8[j];
            unpack8(vq[i], t8);
#pragma unroll
            for (int j = 0; j < 8; ++j) vf[i * 8 + j] = t8[j]; }
        if (half == 0) { const float* rp = ROPE + (size_t)pc * 16;
#pragma unroll
            for (int j = 0; j < 8; ++j) { const float c = rp[j], s = rp[8 + j], x1 = kf[j], x2 = kf[8 + j]; kf[j] = x1 * c - x2 * s; kf[8 + j] = x2 * c + x1 * s; } }
#pragma unroll
        for (int i = 0; i < 4; ++i) { float t8[8];
#pragma unroll
            for (int j = 0; j < 8; ++j) t8[j] = kf[i * 8 + j];
            *(LAS v4u*)(KS + kv * KS_PITCH + half * 64 + i * 16) = pack8(t8); }
        if (nb == SEQ / 128 - 1 && kv >= 128) {
            float* ko = a.out + O_KWP + ((size_t)(b * 128 + kv - 128) * 2 + kvh) * 64 + half * 32; float* vo = a.out + O_VWP + ((size_t)(b * 128 + kv - 128) * 2 + kvh) * 64 + half * 32;
#pragma unroll
            for (int i = 0; i < 8; ++i) { *(f32x4*)(ko + 4 * i) = (f32x4){kf[4 * i], kf[4 * i + 1], kf[4 * i + 2], kf[4 * i + 3]}; *(f32x4*)(vo + 4 * i) = (f32x4){vf[4 * i], vf[4 * i + 1], vf[4 * i + 2], vf[4 * i + 3]}; }
        }
#pragma unroll
        for (int i = 0; i < 4; ++i) { const unsigned w4[4] = {vq[i].x, vq[i].y, vq[i].z, vq[i].w};
#pragma unroll
            for (int j = 0; j < 4; ++j) { *(LAS unsigned short*)(VT + (half * 32 + i * 8 + 2 * j) * VT_PITCH + kv * 2) = (unsigned short)(w4[j] & 0xffffu);
                *(LAS unsigned short*)(VT + (half * 32 + i * 8 + 2 * j + 1) * VT_PITCH + kv * 2) = (unsigned short)(w4[j] >> 16); } }
    }
    __syncthreads();
    const int g = F.wave >> 1, qh = F.wave & 1, l31 = F.lane & 31, hi = F.lane >> 5, head = kvh * 4 + g;
    const float sk = a.in[9][head] * LOG2E;
#pragma unroll 1
    for (int qq = 0; qq < 2; ++qq) {
        const int qb = qh * 2 + qq, qi = qb * 32 + l31, pq = nb * 128 + qi; const size_t grow = (size_t)b * SEQ + pq;
        bf16x8 qf[4]; load_q(Z + grow * INW + ZQ + head * 64 + hi * 8, ROPE + (size_t)pq * 16, hi, qf);
        f32x16 st[5];
#pragma unroll
        for (int tl = 0; tl < 5; ++tl) { const int kb = qb * 32 + tl * 32; f32x16 acc = {};
#pragma unroll
            for (int d0 = 0; d0 < 4; ++d0) { const bf16x8 kfr = *(const LAS bf16x8*)(KS + (kb + l31) * KS_PITCH + d0 * 32 + hi * 16); acc = MFMA32(kfr, qf[d0], acc); }
            st[tl] = acc; }
#pragma unroll
        for (int tl = 0; tl < 5; ++tl)
#pragma unroll
            for (int r = 0; r < 16; ++r) { const int sj = qb * 32 + tl * 32 + crow(r, hi); const bool ok = sj > qi && sj <= qi + 128 && (nb > 0 || sj >= 128); if (!ok) st[tl][r] = -INFINITY; }
        bf16x8 pf[5][2]; softmax5(st, sk, pf);
        f32x16 o[2] = {};
#pragma unroll
        for (int tl = 0; tl < 5; ++tl)
#pragma unroll
            for (int s2 = 0; s2 < 2; ++s2)
#pragma unroll
                for (int db = 0; db < 2; ++db) { const int kv0 = qb * 32 + tl * 32 + 16 * s2 + 4 * hi; const LAS unsigned char* vp = VT + (db * 32 + l31) * VT_PITCH + kv0 * 2;
                    const s16x4 lo = *(const LAS s16x4*)vp, h4 = *(const LAS s16x4*)(vp + 16);
                    const bf16x8 vfr = {lo[0], lo[1], lo[2], lo[3], h4[0], h4[1], h4[2], h4[3]};
                    o[db] = MFMA32(pf[tl][s2], vfr, o[db]); }
#pragma unroll
        for (int db = 0; db < 2; ++db)
#pragma unroll
            for (int r = 0; r < 16; ++r) MIX[((size_t)b * SEQ + nb * 128 + qb * 32 + crow(r, hi)) * D + head * 64 + db * 32 + l31] = (bf16)f2bf(o[db][r]);
    }
    __syncthreads();
}
__device__ __forceinline__ void attn_sample_task(const Args& a, Frame& F, int bs, int kvh) {
    const bf16* Z = (const bf16*)(a.ws + WS_Z); const float* ROPE = (const float*)(a.ws + WS_ROPE); bf16* MIX = (bf16*)(a.ws + WS_MIX);
    const float* ck = a.in[2]; const float* cv = a.in[3];
    const int l31 = F.lane & 31, hi = F.lane >> 5, t = l31 >> 2, g = l31 & 3, head = kvh * 4 + g;
    const size_t r0 = (size_t)MP + bs * 8;
    bf16x8 qf[4]; load_q(Z + (r0 + t) * INW + ZQ + head * 64 + hi * 8, ROPE + (size_t)(4096 + t) * 16, hi, qf);
    const float sk = a.in[9][head] * LOG2E;
    f32x16 st[5];
#pragma unroll
    for (int tl = 0; tl < 4; ++tl) { const float* kp = ck + ((size_t)(bs * 128 + tl * 32 + l31) * 2 + kvh) * 64 + hi * 8; f32x16 acc = {};
#pragma unroll
        for (int d0 = 0; d0 < 4; ++d0) { const f32x4 a0 = *(const f32x4*)(kp + d0 * 16), a1 = *(const f32x4*)(kp + d0 * 16 + 4);
            v4u w; w.x = cvtpk(a0.x, a0.y); w.y = cvtpk(a0.z, a0.w); w.z = cvtpk(a1.x, a1.y); w.w = cvtpk(a1.z, a1.w);
            acc = MFMA32(__builtin_bit_cast(bf16x8, w), qf[d0], acc); }
        st[tl] = acc; }
    {
        const int tn = l31 & 7; const bf16* kp = Z + (r0 + tn) * INW + ZK + kvh * 64 + hi * 8;
        v4u raw[4];
#pragma unroll
        for (int d0 = 0; d0 < 4; ++d0) raw[d0] = *(const v4u*)(kp + d0 * 16);
        float x[8], xp[8]; unpack8(raw[0], x);
#pragma unroll
        for (int j = 0; j < 8; ++j) xp[j] = __shfl_xor(x[j], 32);
        rot8(x, xp, ROPE + (size_t)(4096 + tn) * 16, hi);
        raw[0] = pack8(x);
        f32x16 acc = {};
#pragma unroll
        for (int d0 = 0; d0 < 4; ++d0) { v4u w = raw[d0]; if (l31 >= 8) w = (v4u){0u, 0u, 0u, 0u}; acc = MFMA32(__builtin_bit_cast(bf16x8, w), qf[d0], acc); }
        st[4] = acc;
    }
#pragma unroll
    for (int tl = 0; tl < 5; ++tl)
#pragma unroll
        for (int r = 0; r < 16; ++r) { const int sj = tl * 32 + crow(r, hi); const bool ok = sj > t && sj <= t + 128 && sj < 136; if (!ok) st[tl][r] = -INFINITY; }
    bf16x8 pf[5][2]; softmax5(st, sk, pf);
    f32x16 o[2] = {};
#pragma unroll
    for (int tl = 0; tl < 4; ++tl)
#pragma unroll
        for (int s2 = 0; s2 < 2; ++s2)
#pragma unroll
            for (int db = 0; db < 2; ++db) { float x[8];
#pragma unroll
                for (int j = 0; j < 8; ++j) { const int kv = tl * 32 + 16 * s2 + 8 * (j >> 2) + 4 * hi + (j & 3); x[j] = cv[((size_t)(bs * 128 + kv) * 2 + kvh) * 64 + db * 32 + l31]; }
                o[db] = MFMA32(pf[tl][s2], __builtin_bit_cast(bf16x8, pack8(x)), o[db]); }
#pragma unroll
    for (int db = 0; db < 2; ++db) { bf16x8 vfr = {0, 0, 0, 0, 0, 0, 0, 0};
#pragma unroll
        for (int j = 0; j < 4; ++j) vfr[j] = (short)Z[(r0 + 4 * hi + j) * INW + ZV + kvh * 64 + db * 32 + l31];
        o[db] = MFMA32(pf[4][0], vfr, o[db]); }
#pragma unroll
    for (int db = 0; db < 2; ++db)
#pragma unroll
        for (int r = 0; r < 16; ++r) { const int q = crow(r, hi); MIX[(r0 + (q >> 2)) * D + (kvh * 4 + (q & 3)) * 64 + db * 32 + l31] = (bf16)f2bf(o[db][r]); }
    for (int idx = F.lane; idx < 512; idx += 64) { const int tn = idx >> 6, d = idx & 63; const bf16* zr = Z + (r0 + tn) * INW + kvh * 64; const float* rp = ROPE + (size_t)(4096 + tn) * 16;
        float kval = bf2f(zr[ZK + d]);
        if (d < 8) kval = kval * rp[d] - bf2f(zr[ZK + d + 8]) * rp[8 + d]; else if (d < 16) kval = kval * rp[d - 8] + bf2f(zr[ZK + d - 8]) * rp[d];
        const size_t oo = ((size_t)(bs * 128 + 120 + tn) * 2 + kvh) * 64 + d;
        a.out[O_KWS + oo] = kval; a.out[O_VWS + oo] = bf2f(zr[ZV + d]); }
}
__device__ __forceinline__ int gvt_swz(int R) { return (R & 15) ^ ((R >> 3) & 15); }
__device__ __forceinline__ void sgu_prompt_unit(const Args& a, Frame& F, int b, int c) {
    const bf16* Z = (const bf16*)(a.ws + WS_Z); bf16* MIX = (bf16*)(a.ws + WS_MIX); const bf16* WST = (const bf16*)(a.ws + WS_WST);
    LAS unsigned char* GVT = F.lds + RING_OFF;
    const size_t R0 = (size_t)b * SEQ + c * 128;
    {
        float lg[8], lb[8];
        { const f32x4 g0 = *(const f32x4*)(a.in[10] + 8 * F.lane), g1 = *(const f32x4*)(a.in[10] + 8 * F.lane + 4), b0 = *(const f32x4*)(a.in[11] + 8 * F.lane), b1 = *(const f32x4*)(a.in[11] + 8 * F.lane + 4);
          lg[0] = g0.x; lg[1] = g0.y; lg[2] = g0.z; lg[3] = g0.w; lg[4] = g1.x; lg[5] = g1.y; lg[6] = g1.z; lg[7] = g1.w;
          lb[0] = b0.x; lb[1] = b0.y; lb[2] = b0.z; lb[3] = b0.w; lb[4] = b1.x; lb[5] = b1.y; lb[6] = b1.z; lb[7] = b1.w; }
        unsigned gp[16][4];
#pragma unroll
        for (int tt = 0; tt < 16; ++tt) { const v4u raw = *(const v4u*)(Z + (R0 + 16 * F.wave + tt) * INW + ZG + 8 * F.lane);
            float x[8]; unpack8(raw, x); float s = 0.f;
#pragma unroll
            for (int i = 0; i < 8; ++i) { x[i] = gelu_tanh(x[i]); s += x[i]; }
            const float mean = wave_sum(s) * (1.f / 512.f); float q = 0.f;
#pragma unroll
            for (int i = 0; i < 8; ++i) { x[i] -= mean; q += x[i] * x[i]; }
            const float rstd = 1.0f / sqrtf(wave_sum(q) * (1.f / 512.f) + LN_EPS);
#pragma unroll
            for (int i = 0; i < 8; ++i) x[i] = x[i] * rstd * lg[i] + lb[i];
#pragma unroll
            for (int i = 0; i < 4; ++i) gp[tt][i] = cvtpk(x[2 * i], x[2 * i + 1]); }
#pragma unroll
        for (int tg = 0; tg < 2; ++tg)
#pragma unroll
            for (int i = 0; i < 8; ++i) { v4u w; const int sh = (i & 1) * 16, ii = i >> 1;
                w.x = ((gp[8 * tg + 0][ii] >> sh) & 0xffffu) | (((gp[8 * tg + 1][ii] >> sh) & 0xffffu) << 16);
                w.y = ((gp[8 * tg + 2][ii] >> sh) & 0xffffu) | (((gp[8 * tg + 3][ii] >> sh) & 0xffffu) << 16);
                w.z = ((gp[8 * tg + 4][ii] >> sh) & 0xffffu) | (((gp[8 * tg + 5][ii] >> sh) & 0xffffu) << 16);
                w.w = ((gp[8 * tg + 6][ii] >> sh) & 0xffffu) | (((gp[8 * tg + 7][ii] >> sh) & 0xffffu) << 16);
                const int R = 8 * F.lane + i, ch = 2 * F.wave + tg;
                *(LAS v4u*)(GVT + R * 256 + 16 * (ch ^ gvt_swz(R))) = w; }
    }
    __syncthreads();
    {
        const int hh = F.wave, l31 = F.lane & 31, hi = F.lane >> 5; const bf16* Wt = WST + (size_t)hh * 16384; const float* bs_ = a.in[13] + hh * 128;
#pragma unroll
        for (int ti = 0; ti < 4; ++ti) { f32x16 acc[2] = {};
#pragma unroll
            for (int ks = 0; ks < 2 * ti + 2; ++ks) { const bf16x8 afr = *(const bf16x8*)(Wt + (32 * ti + l31) * 128 + 16 * ks + 8 * hi);
#pragma unroll
                for (int db = 0; db < 2; ++db) { const int R = hh * 64 + db * 32 + l31, ch = 2 * ks + hi; const bf16x8 bfr = *(const LAS bf16x8*)(GVT + R * 256 + 16 * (ch ^ gvt_swz(R))); acc[db] = MFMA32(afr, bfr, acc[db]); } }
#pragma unroll
            for (int db = 0; db < 2; ++db)
#pragma unroll
                for (int r = 0; r < 16; ++r) { const int t = 32 * ti + crow(r, hi), col = hh * 64 + db * 32 + l31; const float sv = acc[db][r] + bs_[t];
                    const float u = gelu_tanh(bf2f(Z[(R0 + t) * INW + ZU + col])); MIX[(R0 + t) * D + 512 + col] = (bf16)f2bf(u * sv); } }
    }
    __syncthreads();
}
__device__ __forceinline__ void sgu_sample_task(const Args& a, Frame& F, int bs) {
    const bf16* Z = (const bf16*)(a.ws + WS_Z); bf16* MIX = (bf16*)(a.ws + WS_MIX);
    const size_t r0 = (size_t)MP + bs * 8; const int lane = F.lane, hh = lane >> 3;
    float lg[8], lb[8];
    { const f32x4 g0 = *(const f32x4*)(a.in[10] + 8 * lane), g1 = *(const f32x4*)(a.in[10] + 8 * lane + 4), b0 = *(const f32x4*)(a.in[11] + 8 * lane), b1 = *(const f32x4*)(a.in[11] + 8 * lane + 4);
      lg[0] = g0.x; lg[1] = g0.y; lg[2] = g0.z; lg[3] = g0.w; lg[4] = g1.x; lg[5] = g1.y; lg[6] = g1.z; lg[7] = g1.w;
      lb[0] = b0.x; lb[1] = b0.y; lb[2] = b0.z; lb[3] = b0.w; lb[4] = b1.x; lb[5] = b1.y; lb[6] = b1.z; lb[7] = b1.w; }
    float gv[8][8];
#pragma unroll
    for (int t = 0; t < 8; ++t) { const v4u raw = *(const v4u*)(Z + (r0 + t) * INW + ZG + 8 * lane);
        float x[8]; unpack8(raw, x); float s = 0.f;
#pragma unroll
        for (int i = 0; i < 8; ++i) { x[i] = gelu_tanh(x[i]); s += x[i]; }
        const float mean = wave_sum(s) * (1.f / 512.f); float q = 0.f;
#pragma unroll
        for (int i = 0; i < 8; ++i) { x[i] -= mean; q += x[i] * x[i]; }
        const float rstd = 1.0f / sqrtf(wave_sum(q) * (1.f / 512.f) + LN_EPS);
#pragma unroll
        for (int i = 0; i < 8; ++i) gv[t][i] = x[i] * rstd * lg[i] + lb[i];
        float* so = a.out + O_SGV + ((size_t)bs * 8 + t) * 512 + 8 * lane;
        *(f32x4*)so = (f32x4){gv[t][0], gv[t][1], gv[t][2], gv[t][3]}; *(f32x4*)(so + 4) = (f32x4){gv[t][4], gv[t][5], gv[t][6], gv[t][7]}; }
    const float* wsp = a.in[12] + (size_t)hh * 16384; const float* bsp = a.in[13] + hh * 128;
#pragma unroll
    for (int t = 0; t < 8; ++t) { float sv[8]; const float bb = bsp[t];
#pragma unroll
        for (int i = 0; i < 8; ++i) sv[i] = bb;
#pragma unroll
        for (int s = 0; s <= t; ++s) { const float w = wsp[t * 128 + s];
#pragma unroll
            for (int i = 0; i < 8; ++i) sv[i] += w * gv[s][i]; }
        const v4u raw = *(const v4u*)(Z + (r0 + t) * INW + ZU + 8 * lane); float u[8]; unpack8(raw, u);
#pragma unroll
        for (int i = 0; i < 8; ++i) u[i] = gelu_tanh(u[i]) * sv[i];
        *(v4u*)(MIX + (r0 + t) * D + 512 + 8 * lane) = pack8(u); }
}
__device__ __forceinline__ void phase_mix(const Args& a, Frame& F) {
    for (int i = F.vcu; i < 2 * DECB; i += F.G) if (F.wave == 0) attn_sample_task(a, F, i >> 1, i & 1);
    for (int i = F.vcu; i < DECB; i += F.G) if (F.wave == 1) sgu_sample_task(a, F, i);
    for (int u = F.vcu; u < BATCH * 32 * 2; u += F.G) attn_prompt_unit(a, F, u >> 6, (u >> 1) & 31, u & 1);
    for (int u = F.vcu; u < BATCH * 32; u += F.G) sgu_prompt_unit(a, F, u >> 5, u & 31);
}

__global__ void __launch_bounds__(NWAVES * 64, 2) hymba_fwd(Args args) {
    extern __shared__ __attribute__((aligned(16))) unsigned char lds[];
    Frame F;
    F.lds = (LAS unsigned char*)lds;
    F.MISC = (volatile LAS unsigned*)(F.lds + MISC_OFF);
    F.tid = threadIdx.x; F.lane = F.tid & 63; F.wave = __builtin_amdgcn_readfirstlane(F.tid >> 6);
    F.G = gridDim.x; { const int bx = blockIdx.x; F.vcu = (F.G % 8 == 0) ? (bx % 8) * (F.G / 8) + bx / 8 : bx; }
    F.ctl = (gu32*)(args.ws + WS_CTL);
    for (int u = F.tid; u < (LDS_BYTES - LDSCTL_OFF) / 4; u += NWAVES * 64) ((LAS unsigned*)(F.lds + LDSCTL_OFF))[u] = 0u;
    __syncthreads();
    XcdBarrier bar; bar.bar = (unsigned*)(F.ctl + CW_BAR); bar.x = 0; bar.st = nullptr;
    if (N_LAUNCHES != PER_PHASE) bar = xcd_barrier_post((unsigned*)(F.ctl + CW_BAR), F.MISC + 8);
#define GRID_BAR() do { if (N_LAUNCHES != PER_PHASE) xcd_barrier(bar); } while (0)
    const int lo = args.ph_lo, hi = args.ph_hi;
#define IN(k) (lo <= (k) && (k) < hi)
#define BOTH(k) (IN(k) && IN((k) + 1))
    unsigned char* ws = args.ws;
    if (IN(0)) { phase_prep(args, F); if (BOTH(0)) GRID_BAR(); }
    if (IN(1)) { phase_ada(args, F); if (BOTH(1)) GRID_BAR(); }
    if (IN(2)) { phase_xn(args, F); if (BOTH(2)) GRID_BAR(); }
    if (IN(3)) {
        pg8::Gemm g{(const pg8::bf16_t*)(ws + WS_XN), (const pg8::bf16_t*)(ws + WS_WIN), M, INW, D}; pg8::StaticOrder S; S.init(M, INW, F.G, (int)blockIdx.x);
        pg8::EpiPlainBf16 E{(pg8::bf16_t*)(ws + WS_Z), INW};
        pg8::gemm_phase<pg8::EpiPlainBf16, pg8::StaticOrder, PG8_ALIGN, PG8_SP2>(F.lds + RING_OFF, g, S, E);
        if (BOTH(3)) GRID_BAR();
    }
    if (IN(4)) { phase_mix(args, F); if (BOTH(4)) GRID_BAR(); }
    if (IN(5)) {
        pg8::Gemm g{(const pg8::bf16_t*)(ws + WS_MIX), (const pg8::bf16_t*)(ws + WS_WO), M, D, D}; pg8::StaticOrder S; S.init(M, D, F.G, (int)blockIdx.x);
        pg8::EpiResGate E{args.in[0], args.in[1], (const float*)(ws + WS_MOD) + 2 * D, args.out};
        pg8::gemm_phase<pg8::EpiResGate, pg8::StaticOrder, PG8_ALIGN, PG8_SP2>(F.lds + RING_OFF, g, S, E);
        if (BOTH(5)) GRID_BAR();
    }
    if (IN(6)) { phase_ln1(args, F); if (BOTH(6)) GRID_BAR(); }
    if (IN(7)) {
        pg8::Gemm g{(const pg8::bf16_t*)(ws + WS_XN), (const pg8::bf16_t*)(ws + WS_WGU), M, NGU, D}; pg8::StaticOrder S; S.init(M, NGU, F.G, (int)blockIdx.x);
        pg8::EpiSwiGLU E{(pg8::bf16_t*)(ws + WS_H)};
        pg8::gemm_phase<pg8::EpiSwiGLU, pg8::StaticOrder, PG8_ALIGN, PG8_SP2>(F.lds + RING_OFF, g, S, E);
        if (BOTH(7)) GRID_BAR();
    }
    if (IN(8)) {
        pg8::Gemm g{(const pg8::bf16_t*)(ws + WS_H), (const pg8::bf16_t*)(ws + WS_WD), M, D, FF}; pg8::StaticOrder S; S.init(M, D, F.G, (int)blockIdx.x);
        const float* Y1 = (const float*)(ws + WS_Y1);
        pg8::EpiResGate E{Y1, Y1 + (size_t)MP * D, (const float*)(ws + WS_MOD) + 5 * D, args.out};
        pg8::gemm_phase<pg8::EpiResGate, pg8::StaticOrder, PG8_ALIGN, PG8_SP2>(F.lds + RING_OFF, g, S, E);
        if (BOTH(8)) GRID_BAR();
    }
    if (IN(9)) { phase_ln2(args, F); }
#undef IN
#undef BOTH
#undef GRID_BAR
}

extern "C" void kernel_launch(void* const* d_in, const int* in_sizes, int n_in, void* d_out, int out_size, void* d_ws, size_t ws_size, hipStream_t stream) {
    static int grid = 0;
    if (grid == 0) {
        if (n_in != NIN || in_sizes[0] != MP * D || (size_t)out_size != O_END || ws_size < WS_END) { fprintf(stderr, "kernel_launch: unexpected shapes (n_in %d, in0 %d, out %d, ws %zu); nothing launched\n", n_in, n_in > 0 ? in_sizes[0] : -1, out_size, ws_size); grid = -1; return; }
        int dev = 0, cus = 0, per_cu = 0;
        if (hipGetDevice(&dev) != hipSuccess || hipDeviceGetAttribute(&cus, hipDeviceAttributeMultiprocessorCount, dev) != hipSuccess) { fprintf(stderr, "kernel_launch: device query failed\n"); grid = -1; return; }
        if (hipFuncSetAttribute((const void*)hymba_fwd, hipFuncAttributeMaxDynamicSharedMemorySize, LDS_BYTES) != hipSuccess) { fprintf(stderr, "kernel_launch: hipFuncSetAttribute failed\n"); grid = -1; return; }
        if (hipOccupancyMaxActiveBlocksPerMultiprocessor(&per_cu, (const void*)hymba_fwd, NWAVES * 64, LDS_BYTES) != hipSuccess || per_cu < 1) { fprintf(stderr, "kernel_launch: occupancy query reports %d workgroups per CU\n", per_cu); }
        (void)hipGetLastError();
        grid = cus;
    }
    if (grid < 0) return;
    if (hipMemsetAsync((char*)d_ws + WS_CTL, 0, CTL_ZERO_BYTES, stream) != hipSuccess) { fprintf(stderr, "kernel_launch: hipMemsetAsync failed\n"); return; }
    Args a{};
    for (int i = 0; i < NIN; ++i) a.in[i] = (const float*)d_in[i];
    a.out = (float*)d_out; a.ws = (unsigned char*)d_ws;
    for (int li = 0; li < N_LAUNCHES; ++li) {
        a.ph_lo = (N_LAUNCHES == PER_PHASE) ? li : 0; a.ph_hi = (N_LAUNCHES == PER_PHASE) ? li + 1 : PER_PHASE; a.li = li;
        hipLaunchKernelGGL(hymba_fwd, dim3(grid), dim3(NWAVES * 64), LDS_BYTES, stream, a);
        const hipError_t le = hipPeekAtLastError();
        if (le != hipSuccess) { fprintf(stderr, "kernel_launch: launch %d failed: %s\n", li, hipGetErrorName(le)); break; }
    }
}
```
